# Optimizing an MI355X kernel written in HIP

```python
import jax, jax.numpy as jnp
from jax import lax
import numpy as np

D_MODEL = 1024
BATCH = 8
SEQ = 2048
DEPTH = 1

N_META = 16
HEAD_DIM = 64
MIX_WIDTH = D_MODEL
W_A = MIX_WIDTH // 2
W_B = MIX_WIDTH - W_A
N_HEADS_A = W_A // HEAD_DIM
N_HEADS_B = W_B // HEAD_DIM
CONV_A_WIDTH = 3
CONV_B_WIDTH = 31
IN_PROJ_WIDTH = 3 * W_A + 2 * W_B
D_FF = ((8 * D_MODEL // 3 + 255) // 256) * 256
RMS_EPS = 1e-6
LN_EPS = 1e-5

kernel_name = "hybrid_shortconv_conformer_block"


def rms_norm(x, g):
    xf = x.astype(jnp.float32)
    y = xf * lax.rsqrt(jnp.mean(xf * xf, axis=-1, keepdims=True) + RMS_EPS)
    return (y * g.astype(jnp.float32)).astype(x.dtype)


def layer_norm(x, g, b):
    xf = x.astype(jnp.float32)
    mu = jnp.mean(xf, axis=-1, keepdims=True)
    var = jnp.mean(jnp.square(xf - mu), axis=-1, keepdims=True)
    y = (xf - mu) * lax.rsqrt(var + LN_EPS)
    return (y * g.astype(jnp.float32) + b.astype(jnp.float32)).astype(x.dtype)


def causal_depthwise_conv(u, w):
    k = w.shape[0]
    return lax.conv_general_dilated(
        u, w[:, None, :].astype(u.dtype),
        window_strides=(1,), padding=[(k - 1, 0)],
        dimension_numbers=("NWC", "WIO", "NWC"),
        feature_group_count=u.shape[-1])


def mixer(xn, w_in, conv_a_w, conv_b_w, conv_b_bias, ln_b_gain, ln_b_bias, w_out):
    h = jnp.einsum("btd,de->bte", xn, w_in)
    b_gate, c_gate, h_a, glu_val, glu_gate = jnp.split(
        h, [W_A, 2 * W_A, 3 * W_A, 3 * W_A + W_B], axis=-1)
    y_a = b_gate * causal_depthwise_conv(c_gate * h_a, conv_a_w)
    g = glu_val * jax.nn.sigmoid(glu_gate)
    z = causal_depthwise_conv(g, conv_b_w) + conv_b_bias.astype(g.dtype)
    y_b = jax.nn.silu(layer_norm(z, ln_b_gain, ln_b_bias))
    y = jnp.concatenate([y_a, y_b], axis=-1)
    return jnp.einsum("bte,ed->btd", y, w_out)


def swiglu(xn, w_gate, w_up, w_down):
    a = jnp.einsum("btd,df->btf", xn, w_gate)
    u = jnp.einsum("btd,df->btf", xn, w_up)
    return jnp.einsum("btf,fd->btd", jax.nn.silu(a) * u, w_down)


def setup_inputs(seed: int = 0) -> dict:
    key = jax.random.key(seed)
    ks = jax.random.split(key, 20)
    f32 = jnp.float32

    def nrm(k, shape, scale):
        return jax.random.normal(k, shape, f32) * scale

    def gain(k, n):
        return jnp.ones((DEPTH, n), f32) + 0.05 * jax.random.normal(k, (DEPTH, n), f32)

    return {
        "x": jax.random.normal(ks[0], (BATCH, SEQ, D_MODEL), f32),
        "meta_tokens": nrm(ks[1], (N_META, D_MODEL), 1.0),
        "pre_mix_norm": gain(ks[2], D_MODEL),
        "w_in": nrm(ks[3], (DEPTH, D_MODEL, IN_PROJ_WIDTH), D_MODEL ** -0.5),
        "conv_a_w": nrm(ks[4], (DEPTH, CONV_A_WIDTH, W_A), CONV_A_WIDTH ** -0.5),
        "conv_b_w": nrm(ks[5], (DEPTH, CONV_B_WIDTH, W_B), CONV_B_WIDTH ** -0.5),
        "conv_b_bias": nrm(ks[6], (DEPTH, W_B), 0.02),
        "ln_b_gain": gain(ks[7], W_B),
        "ln_b_bias": nrm(ks[8], (DEPTH, W_B), 0.02),
        "w_out": nrm(ks[9], (DEPTH, MIX_WIDTH, D_MODEL), MIX_WIDTH ** -0.5),
        "post_mix_norm": gain(ks[10], D_MODEL),
        "pre_ffn_norm": gain(ks[11], D_MODEL),
        "w_gate": nrm(ks[12], (DEPTH, D_MODEL, D_FF), D_MODEL ** -0.5),
        "w_up": nrm(ks[13], (DEPTH, D_MODEL, D_FF), D_MODEL ** -0.5),
        "w_down": nrm(ks[14], (DEPTH, D_FF, D_MODEL), D_FF ** -0.5),
        "post_ffn_norm": gain(ks[15], D_MODEL),
    }


def reference(x, meta_tokens, pre_mix_norm, w_in, conv_a_w, conv_b_w, conv_b_bias,
              ln_b_gain, ln_b_bias, w_out, post_mix_norm, pre_ffn_norm,
              w_gate, w_up, w_down, post_ffn_norm):
    b = x.shape[0]
    meta = jnp.broadcast_to(meta_tokens[None].astype(x.dtype), (b, N_META, x.shape[-1]))
    h = jnp.concatenate([meta, x], axis=1)
    for l in range(DEPTH):
        mix = mixer(rms_norm(h, pre_mix_norm[l]), w_in[l], conv_a_w[l], conv_b_w[l],
                    conv_b_bias[l], ln_b_gain[l], ln_b_bias[l], w_out[l])
        h = h + rms_norm(mix, post_mix_norm[l])
        ff = swiglu(rms_norm(h, pre_ffn_norm[l]), w_gate[l], w_up[l], w_down[l])
        h = h + rms_norm(ff, post_ffn_norm[l])
    return h[:, N_META:, :]
```

```cpp
#include <hip/hip_runtime.h>
#include <hip/hip_cooperative_groups.h>
#include <cstdio>
#include <cstdint>
namespace cg = cooperative_groups;
namespace pg8 {
#define PG8_LAS __attribute__((address_space(3)))
typedef unsigned short bf16_t;
typedef short bf16x8 __attribute__((ext_vector_type(8)));
typedef float f32x4 __attribute__((ext_vector_type(4)));
typedef unsigned u32x4 __attribute__((ext_vector_type(4)));
constexpr int BM = 256, BK = 64, HALF = 128, HTB = HALF * BK * 2  , STAGE_BYTES = 8 * HTB, NXCD = 8, WGM = 8;

__host__ __device__ __forceinline__ int lds_byte(int r, int c) { const int st = (r >> 4) * 2 + (c >> 5), rr = r & 15, cc = c & 31, ob = rr * 64 + cc * 2; return st * 1024 + (ob ^ (((ob >> 9) & 1) << 5)); }
__host__ __device__ __forceinline__ void stage_rc(int b, int& R, int& C) { const int st = b / 1024, sb = b % 1024, swz = sb ^ (((sb >> 9) & 1) << 5); R = (st >> 1) * 16 + swz / 64; C = (st & 1) * 32 + (swz % 64) / 2; }
__host__ __device__ __forceinline__ int perm32(int rho) { const int n = rho >> 4, i = rho & 15; return 8 * (i >> 2) + 4 * n + (i & 3); }

struct Unit { int pm, pn; };
struct Gemm { const bf16_t* A; const bf16_t* Bt; int M, N, K; };

struct StaticOrder {
    int nM, nN, nwg, G, c;
    __host__ __device__ void init(int M, int N, int G_, int c_) { nM = M / BM; nN = N / BM; nwg = nM * nN; G = G_; c = c_; }
    __host__ __device__ bool next(int i, Unit& u) const {
        const long L = (long)i * G + c; if (L >= nwg) return false;
        int wgid = (int)L; { const int q = nwg / NXCD, r = nwg % NXCD, xcd = wgid % NXCD, off = wgid / NXCD; wgid = (xcd < r ? xcd * (q + 1) : r * (q + 1) + (xcd - r) * q) + off; }
        const int nig = WGM * nN, gid = wgid / nig, fm = gid * WGM, gsz = (nM - fm) < WGM ? (nM - fm) : WGM;
        u.pm = fm + ((wgid % nig) % gsz); u.pn = (wgid % nig) / gsz; return true;
    }
    __device__ __forceinline__ void a_ready(const Unit&) const {}
    __device__ __forceinline__ void done(const Unit&) const {}
};

__device__ __forceinline__ unsigned cvt_pk_bf16(float lo, float hi) { unsigned r; asm volatile("v_cvt_pk_bf16_f32 %0, %1, %2" : "=v"(r) : "v"(lo), "v"(hi)); return r; }
__device__ __forceinline__ float silu_f(float a) { return a * __builtin_amdgcn_rcpf(1.0f + __builtin_amdgcn_exp2f(a * -1.44269504089f)); }
struct EpiBf16 {
    static constexpr bool PERM = true, AFTER_DRAIN = false;
    bf16_t* O; int ldc;
    __device__ __forceinline__ void operator()(const f32x4 (&acc)[2][2][4][2], const Unit& u, int wr, int wc, int fr, int fq) const {
        const int row0 = u.pm * BM + wr * 64 + fr, col0 = u.pn * BM + wc * 32 + 8 * fq;
#pragma unroll
        for (int ai = 0; ai < 2; ++ai)
#pragma unroll
            for (int m = 0; m < 4; ++m) { bf16_t* rowp = O + (size_t)(row0 + ai * HALF + m * 16) * ldc + col0;
#pragma unroll
                for (int bj = 0; bj < 2; ++bj) { const f32x4 v0 = acc[ai][bj][m][0], v1 = acc[ai][bj][m][1];
                    u32x4 w; w.x = cvt_pk_bf16(v0[0], v0[1]); w.y = cvt_pk_bf16(v0[2], v0[3]); w.z = cvt_pk_bf16(v1[0], v1[1]); w.w = cvt_pk_bf16(v1[2], v1[3]);
                    *(u32x4*)(rowp + bj * HALF) = w; } }
    }
};
struct EpiSwiGlu {
    static constexpr bool PERM = true, AFTER_DRAIN = false;
    bf16_t* O; int ldc;
    __device__ __forceinline__ void operator()(const f32x4 (&acc)[2][2][4][2], const Unit& u, int wr, int wc, int fr, int fq) const {
        const int row0 = u.pm * BM + wr * 64 + fr, col0 = u.pn * HALF + wc * 32 + 8 * fq;
#pragma unroll
        for (int ai = 0; ai < 2; ++ai)
#pragma unroll
            for (int m = 0; m < 4; ++m) { bf16_t* rowp = O + (size_t)(row0 + ai * HALF + m * 16) * ldc + col0;
                const f32x4 g0 = acc[ai][0][m][0], g1 = acc[ai][0][m][1], u0 = acc[ai][1][m][0], u1 = acc[ai][1][m][1];
                u32x4 w;
                w.x = cvt_pk_bf16(silu_f(g0[0]) * u0[0], silu_f(g0[1]) * u0[1]); w.y = cvt_pk_bf16(silu_f(g0[2]) * u0[2], silu_f(g0[3]) * u0[3]);
                w.z = cvt_pk_bf16(silu_f(g1[0]) * u1[0], silu_f(g1[1]) * u1[1]); w.w = cvt_pk_bf16(silu_f(g1[2]) * u1[2], silu_f(g1[3]) * u1[3]);
                *(u32x4*)rowp = w; }
    }
};
struct EpiF32 {
    static constexpr bool PERM = false, AFTER_DRAIN = false;
    float* C; int ldc;
    __device__ __forceinline__ void operator()(const f32x4 (&acc)[2][2][4][2], const Unit& u, int wr, int wc, int fr, int fq) const {
        const int row0 = u.pm * BM + wr * 64 + fr, col0 = u.pn * BM + wc * 32 + 4 * fq;
#pragma unroll
        for (int ai = 0; ai < 2; ++ai)
#pragma unroll
            for (int m = 0; m < 4; ++m) { float* rowp = C + (size_t)(row0 + ai * HALF + m * 16) * ldc + col0;
#pragma unroll
                for (int bj = 0; bj < 2; ++bj)
#pragma unroll
                    for (int n = 0; n < 2; ++n) *(f32x4*)(rowp + bj * HALF + n * 16) = acc[ai][bj][m][n]; }
    }
};
template <class Epi, class Sched, bool ALIGN_EPI = false, bool SP2 = false>
__device__ __forceinline__ void gemm_phase(PG8_LAS unsigned char* lds, const Gemm g, const Sched& S, const Epi& E) {
    const int tid = threadIdx.x, wid = __builtin_amdgcn_readfirstlane(tid >> 6), lane = tid & 63, wr = wid >> 2, wc = wid & 3, fr = lane & 15, fq = lane >> 4;
    const int K = g.K, nt = K / BK;
    unsigned voffA[2], voffB[2];
#pragma unroll
    for (int i = 0; i < 2; ++i) { int R, C; stage_rc(tid * 16 + i * 8192, R, C); const int Rb = Epi::PERM ? ((R & ~31) + perm32(R & 31)) : R;
        voffA[i] = (unsigned)(R * K + C) * 2u; voffB[i] = (unsigned)(Rb * K + C) * 2u; }
    const size_t kstep = (size_t)(BK * 2);
    const size_t hstep = (size_t)HALF * K * 2;
    const size_t tstep = 2 * hstep;
    const unsigned ldsw = (unsigned)wid * 1024u;
    const int aoff = lds_byte(wr * 64 + fr, fq * 8), boff = lds_byte(wc * 32 + fr, fq * 8);
#define PG8_SA(b, h) (((b) * 2 + (h)) * HTB)
#define PG8_SB(b, h) ((4 + (b) * 2 + (h)) * HTB)
#define PG8_STAGE(bufoff, gbase, voff) do { _Pragma("unroll") for (int _i = 0; _i < 2; ++_i) \
        __builtin_amdgcn_global_load_lds((const unsigned*)((const char*)(gbase) + (voff)[_i]), (PG8_LAS unsigned*)(lds + (bufoff) + ldsw + _i * 8192), 16, 0, 0); } while (0)
#define PG8_LDA(dst, b, h) do { _Pragma("unroll") for (int m = 0; m < 4; ++m) _Pragma("unroll") for (int k = 0; k < 2; ++k) dst[m][k] = *(const PG8_LAS bf16x8*)(lds + PG8_SA(b, h) + aoff + m * 2048 + k * 1024); } while (0)
#define PG8_LDB(dst, b, h) do { _Pragma("unroll") for (int n = 0; n < 2; ++n) _Pragma("unroll") for (int k = 0; k < 2; ++k) dst[n][k] = *(const PG8_LAS bf16x8*)(lds + PG8_SB(b, h) + boff + n * 2048 + k * 1024); } while (0)
#define PG8_MMA(ai, bj, At, Bt) do { __builtin_amdgcn_s_setprio(1); _Pragma("unroll") for (int m = 0; m < 4; ++m) _Pragma("unroll") for (int n = 0; n < 2; ++n) _Pragma("unroll") for (int k = 0; k < 2; ++k) \
        acc[ai][bj][m][n] = __builtin_amdgcn_mfma_f32_16x16x32_bf16(Bt[n][k], At[m][k], acc[ai][bj][m][n], 0, 0, 0); __builtin_amdgcn_s_setprio(0); } while (0)
#define PG8_WAIT_V(n) asm volatile("s_waitcnt vmcnt(" #n ")" ::: "memory")
#define PG8_WAIT_L(n) asm volatile("s_waitcnt lgkmcnt(" #n ")" ::: "memory")
#define PG8_BAR __builtin_amdgcn_s_barrier()
#define PG8_SCHED __builtin_amdgcn_sched_barrier(0)
    Unit cur, nxt; int ui = 0;
    if (!S.next(0, cur)) return;
    f32x4 acc[2][2][4][2];
#pragma unroll
    for (int a = 0; a < 2; ++a)
#pragma unroll
        for (int b = 0; b < 2; ++b)
#pragma unroll
            for (int m = 0; m < 4; ++m)
#pragma unroll
                for (int n = 0; n < 2; ++n) acc[a][b][m][n] = (f32x4){0.f, 0.f, 0.f, 0.f};
    bf16x8 At[4][2], B0[2][2], B1[2][2];
    const char* cA = (const char*)g.A + (size_t)cur.pm * tstep; const char* cB = (const char*)g.Bt + (size_t)cur.pn * tstep;
    S.a_ready(cur);
    if constexpr (SP2) {
        PG8_STAGE(PG8_SB(0, 0), cB, voffB); PG8_STAGE(PG8_SB(0, 1), cB + hstep, voffB); PG8_STAGE(PG8_SA(0, 0), cA, voffA); PG8_STAGE(PG8_SA(0, 1), cA + hstep, voffA);
        if (wr == 1) PG8_BAR;
        PG8_WAIT_V(2); PG8_BAR;
        PG8_STAGE(PG8_SB(1, 0), cB + kstep, voffB); PG8_STAGE(PG8_SA(1, 0), cA + kstep, voffA); PG8_STAGE(PG8_SB(1, 1), cB + hstep + kstep, voffB);
        PG8_WAIT_V(6); PG8_BAR;
    } else {
        PG8_STAGE(PG8_SB(0, 0), cB, voffB); PG8_STAGE(PG8_SA(0, 0), cA, voffA); PG8_STAGE(PG8_SB(0, 1), cB + hstep, voffB); PG8_STAGE(PG8_SA(0, 1), cA + hstep, voffA);
        if (wr == 1) PG8_BAR;
        PG8_WAIT_V(4); PG8_BAR;
        PG8_STAGE(PG8_SB(1, 0), cB + kstep, voffB); PG8_STAGE(PG8_SA(1, 0), cA + kstep, voffA); PG8_STAGE(PG8_SB(1, 1), cB + hstep + kstep, voffB);
        PG8_WAIT_V(6); PG8_BAR;
    }
    for (;;) {
        const bool has_next = S.next(ui + 1, nxt);
        const char* nA = has_next ? (const char*)g.A + (size_t)nxt.pm * tstep : cA; const char* nB = has_next ? (const char*)g.Bt + (size_t)nxt.pn * tstep : cB;
        for (int t = 0; t < nt; t += 2) {
            const bool last = (t == nt - 2);
            const char* a1 = cA + (size_t)(t + 1) * kstep;
            const char* a2 = last ? nA : cA + (size_t)(t + 2) * kstep; const char* b2 = last ? nB : cB + (size_t)(t + 2) * kstep;
            const char* a3 = a2 + kstep; const char* b3 = b2 + kstep;
            if (last && has_next) S.a_ready(nxt);
            if constexpr (SP2) {
            PG8_LDB(B0, 0, 0); PG8_LDB(B1, 0, 1); PG8_SCHED; PG8_LDA(At, 0, 0); PG8_STAGE(PG8_SA(1, 1), a1 + hstep, voffA);
            PG8_WAIT_V(8); PG8_WAIT_L(0); PG8_BAR; PG8_MMA(0, 0, At, B0); PG8_MMA(0, 1, At, B1); PG8_BAR; PG8_SCHED;
            PG8_LDA(At, 0, 1); PG8_STAGE(PG8_SB(0, 0), b2, voffB); PG8_STAGE(PG8_SB(0, 1), b2 + hstep, voffB); PG8_STAGE(PG8_SA(0, 0), a2, voffA);
            PG8_WAIT_V(8); PG8_WAIT_L(0); PG8_BAR; PG8_MMA(1, 0, At, B0); PG8_MMA(1, 1, At, B1); PG8_BAR; PG8_SCHED;
            PG8_LDB(B0, 1, 0); PG8_LDB(B1, 1, 1); PG8_SCHED; PG8_LDA(At, 1, 0); PG8_STAGE(PG8_SA(0, 1), a2 + hstep, voffA);
            PG8_WAIT_V(8); PG8_WAIT_L(0); PG8_BAR; PG8_MMA(0, 0, At, B0); PG8_MMA(0, 1, At, B1); PG8_BAR; PG8_SCHED;
            PG8_LDA(At, 1, 1); PG8_STAGE(PG8_SB(1, 0), b3, voffB); PG8_STAGE(PG8_SB(1, 1), b3 + hstep, voffB); PG8_STAGE(PG8_SA(1, 0), a3, voffA);
            PG8_WAIT_V(8); PG8_WAIT_L(0); PG8_BAR; PG8_MMA(1, 0, At, B0); PG8_MMA(1, 1, At, B1); PG8_BAR; PG8_SCHED;
            } else {
            PG8_LDB(B0, 0, 0); PG8_SCHED; PG8_LDA(At, 0, 0); PG8_STAGE(PG8_SA(1, 1), a1 + hstep, voffA);
            PG8_WAIT_L(8); PG8_BAR; PG8_WAIT_L(0); PG8_MMA(0, 0, At, B0); PG8_BAR; PG8_SCHED;
            PG8_LDB(B1, 0, 1); PG8_STAGE(PG8_SB(0, 0), b2, voffB);
            PG8_BAR; PG8_WAIT_L(0); PG8_MMA(0, 1, At, B1); PG8_BAR;
            PG8_LDA(At, 0, 1); PG8_STAGE(PG8_SA(0, 0), a2, voffA);
            PG8_BAR; PG8_WAIT_L(0); PG8_MMA(1, 0, At, B0); PG8_BAR; PG8_SCHED;
            PG8_STAGE(PG8_SB(0, 1), b2 + hstep, voffB);
            PG8_WAIT_V(6); PG8_BAR; PG8_MMA(1, 1, At, B1); PG8_BAR;
            PG8_LDB(B0, 1, 0); PG8_SCHED; PG8_LDA(At, 1, 0); PG8_STAGE(PG8_SA(0, 1), a2 + hstep, voffA);
            PG8_WAIT_L(8); PG8_BAR; PG8_WAIT_L(0); PG8_MMA(0, 0, At, B0); PG8_BAR; PG8_SCHED;
            PG8_LDB(B1, 1, 1); PG8_STAGE(PG8_SB(1, 0), b3, voffB);
            PG8_BAR; PG8_WAIT_L(0); PG8_MMA(0, 1, At, B1); PG8_BAR;
            PG8_LDA(At, 1, 1); PG8_STAGE(PG8_SA(1, 0), a3, voffA);
            PG8_BAR; PG8_WAIT_L(0); PG8_MMA(1, 0, At, B0); PG8_BAR; PG8_SCHED;
            PG8_STAGE(PG8_SB(1, 1), b3 + hstep, voffB);
            PG8_WAIT_V(6); PG8_BAR; PG8_MMA(1, 1, At, B1); PG8_BAR;
            }
        }
        if constexpr (ALIGN_EPI) { if (wr == 0) PG8_BAR; }
        if constexpr (!Epi::AFTER_DRAIN) { E(acc, cur, wr, wc, fr, fq); S.done(cur); }
        if (!has_next) break;
#pragma unroll
        for (int a = 0; a < 2; ++a)
#pragma unroll
            for (int b = 0; b < 2; ++b)
#pragma unroll
                for (int m = 0; m < 4; ++m)
#pragma unroll
                    for (int n = 0; n < 2; ++n) acc[a][b][m][n] = (f32x4){0.f, 0.f, 0.f, 0.f};
        cur = nxt; cA = nA; cB = nB; ++ui;
        if constexpr (ALIGN_EPI) { if (wr == 1) PG8_BAR; }
    }
    PG8_WAIT_V(0);
    if constexpr (!ALIGN_EPI) { if (wr == 0) PG8_BAR; }
    PG8_BAR;
    if constexpr (Epi::AFTER_DRAIN) { E.fused(acc, cur, wr, wc, fr, fq, lds, wid, lane); S.done(cur); }
#undef PG8_SA
#undef PG8_SB
#undef PG8_STAGE
#undef PG8_LDA
#undef PG8_LDB
#undef PG8_MMA
#undef PG8_WAIT_V
#undef PG8_WAIT_L
#undef PG8_BAR
#undef PG8_SCHED
}
}

#ifndef MK_N_LAUNCHES
#define MK_N_LAUNCHES 1
#endif
constexpr int NPHASE = 8;
constexpr int NB = 8, SEQ = 2048, D = 1024, NMETA = 16, WA = 512, WB = 512, NIN = 2560, FF = 2816, KB_W = 31;
constexpr int MX = NB * SEQ;
constexpr int M1 = 65 * 256;
constexpr float RMS_EPS = 1e-6f, LN_EPS = 1e-5f;

constexpr size_t MiB = 1u << 20;
constexpr size_t WS_WIN = 1 * MiB, WS_WOUT = 6 * MiB, WS_WGU = 8 * MiB, WS_WDN = 19 * MiB;
constexpr size_t WS_XN = 25 * MiB;
constexpr size_t WS_MIX = 58 * MiB;
constexpr size_t WS_HP = 122 * MiB;
constexpr size_t WS_Y = 204 * MiB;
constexpr size_t WS_ACT = 122 * MiB;
constexpr size_t WS_END = 236 * MiB;
static_assert(WS_WIN + (size_t)NIN * D * 2 <= WS_WOUT && WS_WOUT + (size_t)D * D * 2 <= WS_WGU && WS_WGU + (size_t)2 * FF * D * 2 <= WS_WDN && WS_WDN + (size_t)D * FF * 2 <= WS_XN, "ws map 1");
static_assert(WS_XN + (size_t)M1 * D * 2 <= WS_MIX && WS_MIX + (size_t)MX * D * 4 <= WS_HP && WS_HP + (size_t)M1 * NIN * 2 <= WS_Y && WS_Y + (size_t)MX * D * 2 <= WS_END && WS_ACT + (size_t)MX * FF * 2 <= WS_END, "ws map 2");

constexpr int LDS_BYTES = 147456;

#define LAS __attribute__((address_space(3)))
typedef unsigned short bf16;
typedef unsigned v4u __attribute__((ext_vector_type(4)));
typedef unsigned v2u __attribute__((ext_vector_type(2)));
typedef float f32x4 __attribute__((ext_vector_type(4)));
typedef float f32x2 __attribute__((ext_vector_type(2)));
#define LDS_WAIT() asm volatile("s_waitcnt lgkmcnt(0)" ::: "memory")
__device__ __forceinline__ unsigned pk2(float lo, float hi) { return pg8::cvt_pk_bf16(lo, hi); }
__device__ __forceinline__ float bf_lo(unsigned w) { return __uint_as_float(w << 16); }
__device__ __forceinline__ float bf_hi(unsigned w) { return __uint_as_float(w & 0xffff0000u); }
__device__ __forceinline__ float sigmoid_f(float a) { return __builtin_amdgcn_rcpf(1.0f + __builtin_amdgcn_exp2f(a * -1.44269504089f)); }
__device__ __forceinline__ float wave_sum(float v) {
#pragma unroll
    for (int o = 1; o < 64; o <<= 1) v += __shfl_xor(v, o);
    return v;
}
__device__ __forceinline__ float dot4(f32x4 a) { return (a.x * a.x + a.y * a.y) + (a.z * a.z + a.w * a.w); }

__device__ __forceinline__ void transpose_item(const float* W, int N, int K, bf16* WT, int k0, int n0, int orow0, LAS float* scr, int lane) {
#pragma unroll 8
    for (int i = 0; i < 32; ++i) { const int kk = 2 * i + (lane >> 5); scr[kk * 33 + (lane & 31)] = W[(size_t)(k0 + kk) * N + n0 + (lane & 31)]; }
    LDS_WAIT(); asm volatile("" ::: "memory");
    const int c = lane & 7;
#pragma unroll
    for (int j = 0; j < 4; ++j) { const int n = (lane >> 3) + 8 * j; const LAS float* s = scr + (8 * c) * 33 + n;
        v4u o; o.x = pk2(s[0 * 33], s[1 * 33]); o.y = pk2(s[2 * 33], s[3 * 33]); o.z = pk2(s[4 * 33], s[5 * 33]); o.w = pk2(s[6 * 33], s[7 * 33]);
        *(v4u*)(WT + (size_t)(orow0 + n) * K + k0 + 8 * c) = o; }
    LDS_WAIT(); asm volatile("" ::: "memory");
}
__device__ __forceinline__ void rms_row_to_bf16(const float* xrow, const float* gain, bf16* orow, int lane) {
    const f32x4* xr = (const f32x4*)xrow + lane; const f32x4* gr = (const f32x4*)gain + lane;
    f32x4 v[4]; float s = 0.f;
#pragma unroll
    for (int j = 0; j < 4; ++j) { v[j] = xr[64 * j]; s += dot4(v[j]); }
    const float r = 1.0f / sqrtf(wave_sum(s) * (1.0f / D) + RMS_EPS);
    v2u* o8 = (v2u*)orow + lane;
#pragma unroll
    for (int j = 0; j < 4; ++j) { const f32x4 g = gr[64 * j]; v2u w; w.x = pk2(v[j].x * r * g.x, v[j].y * r * g.y); w.y = pk2(v[j].z * r * g.z, v[j].w * r * g.w); o8[64 * j] = w; }
}

struct Args { const float* in[16]; float* out; unsigned char* ws; int ph_lo, ph_hi; };

__device__ __forceinline__ void p0_prologue(const Args& a, LAS unsigned char* lds, int wave, int lane, int G) {
    LAS float* scr = (LAS float*)(lds + wave * 16384);
    const int gw = blockIdx.x * 8 + wave, NGW = G * 8;
    bf16* Win_t = (bf16*)(a.ws + WS_WIN); bf16* Wout_t = (bf16*)(a.ws + WS_WOUT); bf16* Wgu_t = (bf16*)(a.ws + WS_WGU); bf16* Wdn_t = (bf16*)(a.ws + WS_WDN);
    constexpr int I_IN = (D / 64) * (NIN / 32), I_OUT = (D / 64) * (D / 32), I_G = (D / 64) * (FF / 32), I_DN = (FF / 64) * (D / 32);
    constexpr int NITEMS = I_IN + I_OUT + 2 * I_G + I_DN;
    for (int it = gw; it < NITEMS; it += NGW) {
        int r = it;
        if (r < I_IN) { const int nb = NIN / 32, k0 = (r / nb) * 64, n0 = (r % nb) * 32; transpose_item(a.in[3], NIN, D, Win_t, k0, n0, n0, scr, lane); continue; } r -= I_IN;
        if (r < I_OUT) { const int nb = D / 32, k0 = (r / nb) * 64, n0 = (r % nb) * 32; transpose_item(a.in[9], D, D, Wout_t, k0, n0, n0, scr, lane); continue; } r -= I_OUT;
        if (r < I_G) { const int nb = FF / 32, k0 = (r / nb) * 64, n0 = (r % nb) * 32; transpose_item(a.in[12], FF, D, Wgu_t, k0, n0, (n0 >> 7) * 256 + (n0 & 127), scr, lane); continue; } r -= I_G;
        if (r < I_G) { const int nb = FF / 32, k0 = (r / nb) * 64, n0 = (r % nb) * 32; transpose_item(a.in[13], FF, D, Wgu_t, k0, n0, (n0 >> 7) * 256 + 128 + (n0 & 127), scr, lane); continue; } r -= I_G;
        { const int nb = D / 32, k0 = (r / nb) * 64, n0 = (r % nb) * 32; transpose_item(a.in[14], D, FF, Wdn_t, k0, n0, n0, scr, lane); }
    }
    bf16* XN = (bf16*)(a.ws + WS_XN);
    for (int m = gw; m < MX + NMETA; m += NGW) {
        const float* src = m < MX ? a.in[0] + (size_t)m * D : a.in[1] + (size_t)(m - MX) * D;
        rms_row_to_bf16(src, a.in[2], XN + (size_t)m * D, lane);
    }
}

constexpr int CV_TT = 64, CV_ROWS = CV_TT + KB_W - 1  , CV_ZOFF = CV_ROWS * 1024;
static_assert(CV_ZOFF + 16 * 512 * 4 <= 131072, "conv LDS");
__device__ __forceinline__ size_t hp_row(int b, int p) { return p < NMETA ? (size_t)(MX + p) : (size_t)(b * SEQ + p - NMETA); }
__device__ __forceinline__ void p2_conv(const Args& a, LAS unsigned char* lds, int tid, int wave, int lane, int G) {
    const bf16* HP = (const bf16*)(a.ws + WS_HP); bf16* Y = (bf16*)(a.ws + WS_Y);
    const float* conv_a_w = a.in[4]; const float* conv_b_w = a.in[5]; const float* conv_b_bias = a.in[6]; const float* ln_g = a.in[7]; const float* ln_b = a.in[8];
    const int cp = tid & 255, sub = tid >> 8;
    for (int unit = blockIdx.x; unit < NB * (SEQ / CV_TT); unit += G) {
        const int b = unit / (SEQ / CV_TT), t0 = (unit % (SEQ / CV_TT)) * CV_TT;
        for (int i = wave; i < CV_ROWS; i += 8) {
            const int p = t0 - 14 + i; v4u o = {0u, 0u, 0u, 0u};
            if (p >= 0) {
                const bf16* hp = HP + hp_row(b, p) * NIN;
                const v4u v = *(const v4u*)(hp + 1536 + 8 * lane), gt = *(const v4u*)(hp + 2048 + 8 * lane);
#pragma unroll
                for (int e = 0; e < 4; ++e) o[e] = pk2(bf_lo(v[e]) * sigmoid_f(bf_lo(gt[e])), bf_hi(v[e]) * sigmoid_f(bf_hi(gt[e])));
            }
            *(LAS v4u*)(lds + i * 1024 + lane * 16) = o;
        }
        {
            float wa[3][8];
#pragma unroll
            for (int k = 0; k < 3; ++k) { const f32x4 w0 = *(const f32x4*)(conv_a_w + k * WA + 8 * lane), w1 = *(const f32x4*)(conv_a_w + k * WA + 8 * lane + 4);
                wa[k][0] = w0.x; wa[k][1] = w0.y; wa[k][2] = w0.z; wa[k][3] = w0.w; wa[k][4] = w1.x; wa[k][5] = w1.y; wa[k][6] = w1.z; wa[k][7] = w1.w; }
            float u2[8], u1[8], u0[8];
#pragma unroll
            for (int e = 0; e < 8; ++e) { u2[e] = 0.f; u1[e] = 0.f; }
#pragma unroll
            for (int tt = -2; tt < 8; ++tt) {
                const int tk = t0 + wave * 8 + tt, p = NMETA + tk;
                const bf16* hp = HP + hp_row(b, p) * NIN;
                const v4u cg = *(const v4u*)(hp + 512 + 8 * lane), ha = *(const v4u*)(hp + 1024 + 8 * lane);
#pragma unroll
                for (int e = 0; e < 4; ++e) { u0[2 * e] = bf_lo(cg[e]) * bf_lo(ha[e]); u0[2 * e + 1] = bf_hi(cg[e]) * bf_hi(ha[e]); }
                if (tt >= 0) {
                    const v4u bg = *(const v4u*)(hp + 8 * lane); v4u o;
#pragma unroll
                    for (int e = 0; e < 4; ++e) {
                        const float y0 = bf_lo(bg[e]) * (wa[0][2 * e] * u2[2 * e] + wa[1][2 * e] * u1[2 * e] + wa[2][2 * e] * u0[2 * e]);
                        const float y1 = bf_hi(bg[e]) * (wa[0][2 * e + 1] * u2[2 * e + 1] + wa[1][2 * e + 1] * u1[2 * e + 1] + wa[2][2 * e + 1] * u0[2 * e + 1]);
                        o[e] = pk2(y0, y1); }
                    *(v4u*)(Y + (size_t)(b * SEQ + tk) * D + 8 * lane) = o;
                }
#pragma unroll
                for (int e = 0; e < 8; ++e) { u2[e] = u1[e]; u1[e] = u0[e]; }
            }
        }
        __syncthreads();
        {
            f32x2 wb[KB_W];
#pragma unroll
            for (int k = 0; k < KB_W; ++k) wb[k] = *(const f32x2*)(conv_b_w + k * WB + 2 * cp);
            const f32x2 cb = *(const f32x2*)(conv_b_bias + 2 * cp);
            const f32x4 lg0 = *(const f32x4*)(ln_g + 8 * lane), lg1 = *(const f32x4*)(ln_g + 8 * lane + 4), lb0 = *(const f32x4*)(ln_b + 8 * lane), lb1 = *(const f32x4*)(ln_b + 8 * lane + 4);
            for (int tb = 0; tb < 4; ++tb) {
                const int tl0 = sub * 32 + tb * 8;
                f32x2 z[8];
#pragma unroll
                for (int j = 0; j < 8; ++j) z[j] = cb;
#pragma unroll
                for (int r = 0; r < 8 + KB_W - 1; ++r) {
                    const unsigned gw = *(const LAS unsigned*)(lds + (tl0 + r) * 1024 + cp * 4); const f32x2 g = {bf_lo(gw), bf_hi(gw)};
#pragma unroll
                    for (int j = 0; j < 8; ++j) { const int k = r - j; if (k >= 0 && k < KB_W) z[j] += wb[k] * g; }
                }
#pragma unroll
                for (int j = 0; j < 8; ++j) *(LAS f32x2*)(lds + CV_ZOFF + ((sub * 8 + j) * 512 + 2 * cp) * 4) = z[j];
                __syncthreads();
#pragma unroll
                for (int q = 0; q < 2; ++q) {
                    const LAS f32x4* zr = (const LAS f32x4*)(lds + CV_ZOFF + ((q * 8 + wave) * 512 + 8 * lane) * 4);
                    f32x4 z0 = zr[0], z1 = zr[1];
                    const float mean = wave_sum((z0.x + z0.y) + (z0.z + z0.w) + (z1.x + z1.y) + (z1.z + z1.w)) * (1.0f / WB);
                    z0 = z0 - mean; z1 = z1 - mean;
                    const float rstd = 1.0f / sqrtf(wave_sum(dot4(z0) + dot4(z1)) * (1.0f / WB) + LN_EPS);
                    z0 = z0 * rstd * lg0 + lb0; z1 = z1 * rstd * lg1 + lb1;
                    v4u o; o.x = pk2(pg8::silu_f(z0.x), pg8::silu_f(z0.y)); o.y = pk2(pg8::silu_f(z0.z), pg8::silu_f(z0.w)); o.z = pk2(pg8::silu_f(z1.x), pg8::silu_f(z1.y)); o.w = pk2(pg8::silu_f(z1.z), pg8::silu_f(z1.w));
                    const int tk = t0 + q * 32 + tb * 8 + wave;
                    *(v4u*)(Y + (size_t)(b * SEQ + tk) * D + WA + 8 * lane) = o;
                }
                __syncthreads();
            }
        }
    }
}

__device__ __forceinline__ void p4_norm(const Args& a, int wave, int lane, int G) {
    const int gw = blockIdx.x * 8 + wave, NGW = G * 8;
    const float* MIX = (const float*)(a.ws + WS_MIX); bf16* XN = (bf16*)(a.ws + WS_XN);
    const f32x4* g1 = (const f32x4*)a.in[10] + lane; const f32x4* g2 = (const f32x4*)a.in[11] + lane;
    for (int m = gw; m < MX; m += NGW) {
        const f32x4* mr = (const f32x4*)(MIX + (size_t)m * D) + lane; const f32x4* xr = (const f32x4*)(a.in[0] + (size_t)m * D) + lane; f32x4* orow = (f32x4*)(a.out + (size_t)m * D) + lane;
        f32x4 v[4], xv[4]; float s = 0.f;
#pragma unroll
        for (int j = 0; j < 4; ++j) { v[j] = mr[64 * j]; xv[j] = xr[64 * j]; s += dot4(v[j]); }
        const float r = 1.0f / sqrtf(wave_sum(s) * (1.0f / D) + RMS_EPS); float s2 = 0.f;
#pragma unroll
        for (int j = 0; j < 4; ++j) { v[j] = xv[j] + v[j] * r * g1[64 * j]; orow[64 * j] = v[j]; s2 += dot4(v[j]); }
        const float r2 = 1.0f / sqrtf(wave_sum(s2) * (1.0f / D) + RMS_EPS);
        v2u* o8 = (v2u*)(XN + (size_t)m * D) + lane;
#pragma unroll
        for (int j = 0; j < 4; ++j) { const f32x4 g = g2[64 * j]; v2u w; w.x = pk2(v[j].x * r2 * g.x, v[j].y * r2 * g.y); w.y = pk2(v[j].z * r2 * g.z, v[j].w * r2 * g.w); o8[64 * j] = w; }
    }
}
__device__ __forceinline__ void p7_norm(const Args& a, int wave, int lane, int G) {
    const int gw = blockIdx.x * 8 + wave, NGW = G * 8;
    const float* FFO = (const float*)(a.ws + WS_MIX);
    const f32x4* g1 = (const f32x4*)a.in[15] + lane;
    for (int m = gw; m < MX; m += NGW) {
        const f32x4* fr = (const f32x4*)(FFO + (size_t)m * D) + lane; f32x4* orow = (f32x4*)(a.out + (size_t)m * D) + lane;
        f32x4 v[4], hv[4]; float s = 0.f;
#pragma unroll
        for (int j = 0; j < 4; ++j) { v[j] = fr[64 * j]; hv[j] = orow[64 * j]; s += dot4(v[j]); }
        const float r = 1.0f / sqrtf(wave_sum(s) * (1.0f / D) + RMS_EPS);
#pragma unroll
        for (int j = 0; j < 4; ++j) orow[64 * j] = hv[j] + v[j] * r * g1[64 * j];
    }
}

__global__ void __launch_bounds__(512, 2) fwd_megakernel(Args a) {
    extern __shared__ __attribute__((aligned(16))) unsigned char lds_raw[];
    LAS unsigned char* lds = (LAS unsigned char*)lds_raw;
    cg::grid_group grid = cg::this_grid();
    const int tid = threadIdx.x, lane = tid & 63, wave = __builtin_amdgcn_readfirstlane(tid >> 6), G = gridDim.x;
    const int lo = a.ph_lo, hi = a.ph_hi;
#define IN(k) (lo <= (k) && (k) < hi)
#define SEAM(k) do { if (IN(k) && IN((k) + 1)) grid.sync(); } while (0)
    bf16* XN = (bf16*)(a.ws + WS_XN); bf16* HP = (bf16*)(a.ws + WS_HP); bf16* Y = (bf16*)(a.ws + WS_Y); bf16* ACT = (bf16*)(a.ws + WS_ACT); float* MIX = (float*)(a.ws + WS_MIX);
    const bf16* Win_t = (const bf16*)(a.ws + WS_WIN); const bf16* Wout_t = (const bf16*)(a.ws + WS_WOUT); const bf16* Wgu_t = (const bf16*)(a.ws + WS_WGU); const bf16* Wdn_t = (const bf16*)(a.ws + WS_WDN);

    if (IN(0)) { p0_prologue(a, lds, wave, lane, G); } SEAM(0);
    if (IN(1)) {
        pg8::Gemm g{XN, Win_t, M1, NIN, D}; pg8::StaticOrder S; S.init(M1, NIN, G, (int)blockIdx.x);
        pg8::EpiBf16 E{HP, NIN};
        pg8::gemm_phase<pg8::EpiBf16, pg8::StaticOrder, true, true>(lds, g, S, E);
    } SEAM(1);
    if (IN(2)) { p2_conv(a, lds, tid, wave, lane, G); } SEAM(2);
    if (IN(3)) {
        pg8::Gemm g{Y, Wout_t, MX, D, D}; pg8::StaticOrder S; S.init(MX, D, G, (int)blockIdx.x);
        pg8::EpiF32 E{MIX, D};
        pg8::gemm_phase<pg8::EpiF32, pg8::StaticOrder, true, true>(lds, g, S, E);
    } SEAM(3);
    if (IN(4)) { p4_norm(a, wave, lane, G); } SEAM(4);
    if (IN(5)) {
        pg8::Gemm g{XN, Wgu_t, MX, 2 * FF, D}; pg8::StaticOrder S; S.init(MX, 2 * FF, G, (int)blockIdx.x);
        pg8::EpiSwiGlu E{ACT, FF};
        pg8::gemm_phase<pg8::EpiSwiGlu, pg8::StaticOrder, true, true>(lds, g, S, E);
    } SEAM(5);
    if (IN(6)) {
        pg8::Gemm g{ACT, Wdn_t, MX, D, FF}; pg8::StaticOrder S; S.init(MX, D, G, (int)blockIdx.x);
        pg8::EpiF32 E{MIX, D};
        pg8::gemm_phase<pg8::EpiF32, pg8::StaticOrder, true, true>(lds, g, S, E);
    } SEAM(6);
    if (IN(7)) { p7_norm(a, wave, lane, G); }
#undef IN
#undef SEAM
}

extern "C" void kernel_launch(void* const* d_in, const int* in_sizes, int n_in, void* d_out, int out_size, void* d_ws, size_t ws_size, hipStream_t stream) {
    static int grid = 0;
    if (grid == 0) {
        if (n_in != 16 || in_sizes[0] != MX * D || out_size != MX * D || ws_size < WS_END) { fprintf(stderr, "kernel_launch: unexpected shapes (n_in %d, in0 %d, out %d, ws %zu); nothing launched\n", n_in, n_in > 0 ? in_sizes[0] : -1, out_size, ws_size); grid = -1; return; }
        int dev = 0, cus = 0, per_cu = 0;
        if (hipGetDevice(&dev) != hipSuccess || hipDeviceGetAttribute(&cus, hipDeviceAttributeMultiprocessorCount, dev) != hipSuccess) { grid = -1; return; }
        if (hipFuncSetAttribute((const void*)fwd_megakernel, hipFuncAttributeMaxDynamicSharedMemorySize, LDS_BYTES) != hipSuccess) { fprintf(stderr, "kernel_launch: hipFuncSetAttribute failed\n"); grid = -1; return; }
        if (hipOccupancyMaxActiveBlocksPerMultiprocessor(&per_cu, (const void*)fwd_megakernel, 512, LDS_BYTES) != hipSuccess || per_cu < 1) { fprintf(stderr, "kernel_launch: occupancy query says %d\n", per_cu); per_cu = 1; }
        (void)hipGetLastError();
        grid = cus * per_cu;
    }
    if (grid < 0) return;
    Args a{};
    for (int i = 0; i < 16; ++i) a.in[i] = (const float*)d_in[i];
    a.out = (float*)d_out; a.ws = (unsigned char*)d_ws;
#if MK_N_LAUNCHES == 1
    a.ph_lo = 0; a.ph_hi = NPHASE;
    void* args[] = {&a};
    hipError_t e = hipLaunchCooperativeKernel((const void*)fwd_megakernel, dim3(grid), dim3(512), args, LDS_BYTES, stream);
    if (e != hipSuccess) fprintf(stderr, "kernel_launch: cooperative launch failed: %s (grid %d)\n", hipGetErrorString(e), grid);
#else
    for (int p = 0; p < NPHASE; ++p) { a.ph_lo = p; a.ph_hi = p + 1; hipLaunchKernelGGL(fwd_megakernel, dim3(grid), dim3(512), LDS_BYTES, stream, a); }
#endif
}
```

```cpp
#include <hip/hip_runtime.h>
#include <hip/hip_cooperative_groups.h>
#include <cstdio>
#include <cstdint>
namespace cg = cooperative_groups;
namespace pg8 {
#define PG8_LAS __attribute__((address_space(3)))
typedef unsigned short bf16_t;
typedef short bf16x8 __attribute__((ext_vector_type(8)));
typedef float f32x4 __attribute__((ext_vector_type(4)));
typedef unsigned u32x4 __attribute__((ext_vector_type(4)));
constexpr int BM = 256, BK = 64, HALF = 128, HTB = HALF * BK * 2  , STAGE_BYTES = 8 * HTB, NXCD = 8, WGM = 8;

__host__ __device__ __forceinline__ int lds_byte(int r, int c) { const int st = (r >> 4) * 2 + (c >> 5), rr = r & 15, cc = c & 31, ob = rr * 64 + cc * 2; return st * 1024 + (ob ^ (((ob >> 9) & 1) << 5)); }
__host__ __device__ __forceinline__ void stage_rc(int b, int& R, int& C) { const int st = b / 1024, sb = b % 1024, swz = sb ^ (((sb >> 9) & 1) << 5); R = (st >> 1) * 16 + swz / 64; C = (st & 1) * 32 + (swz % 64) / 2; }
__host__ __device__ __forceinline__ int perm32(int rho) { const int n = rho >> 4, i = rho & 15; return 8 * (i >> 2) + 4 * n + (i & 3); }

struct Unit { int pm, pn; };
struct Gemm { const bf16_t* A; const bf16_t* Bt; int M, N, K; };

struct StaticOrder {
    int nM, nN, nwg, G, c;
    __host__ __device__ void init(int M, int N, int G_, int c_) { nM = M / BM; nN = N / BM; nwg = nM * nN; G = G_; c = c_; }
    __host__ __device__ bool next(int i, Unit& u) const {
        const long L = (long)i * G + c; if (L >= nwg) return false;
        int wgid = (int)L; { const int q = nwg / NXCD, r = nwg % NXCD, xcd = wgid % NXCD, off = wgid / NXCD; wgid = (xcd < r ? xcd * (q + 1) : r * (q + 1) + (xcd - r) * q) + off; }
        const int nig = WGM * nN, gid = wgid / nig, fm = gid * WGM, gsz = (nM - fm) < WGM ? (nM - fm) : WGM;
        u.pm = fm + ((wgid % nig) % gsz); u.pn = (wgid % nig) / gsz; return true;
    }
    __device__ __forceinline__ void a_ready(const Unit&) const {}
    __device__ __forceinline__ void done(const Unit&) const {}
};

__device__ __forceinline__ unsigned cvt_pk_bf16(float lo, float hi) { unsigned r; asm volatile("v_cvt_pk_bf16_f32 %0, %1, %2" : "=v"(r) : "v"(lo), "v"(hi)); return r; }
__device__ __forceinline__ float silu_f(float a) { return a * __builtin_amdgcn_rcpf(1.0f + __builtin_amdgcn_exp2f(a * -1.44269504089f)); }
struct EpiBf16 {
    static constexpr bool PERM = true, AFTER_DRAIN = false;
    bf16_t* O; int ldc;
    __device__ __forceinline__ void operator()(const f32x4 (&acc)[2][2][4][2], const Unit& u, int wr, int wc, int fr, int fq) const {
        const int row0 = u.pm * BM + wr * 64 + fr, col0 = u.pn * BM + wc * 32 + 8 * fq;
#pragma unroll
        for (int ai = 0; ai < 2; ++ai)
#pragma unroll
            for (int m = 0; m < 4; ++m) { bf16_t* rowp = O + (size_t)(row0 + ai * HALF + m * 16) * ldc + col0;
#pragma unroll
                for (int bj = 0; bj < 2; ++bj) { const f32x4 v0 = acc[ai][bj][m][0], v1 = acc[ai][bj][m][1];
                    u32x4 w; w.x = cvt_pk_bf16(v0[0], v0[1]); w.y = cvt_pk_bf16(v0[2], v0[3]); w.z = cvt_pk_bf16(v1[0], v1[1]); w.w = cvt_pk_bf16(v1[2], v1[3]);
                    *(u32x4*)(rowp + bj * HALF) = w; } }
    }
};
struct EpiSwiGlu {
    static constexpr bool PERM = true, AFTER_DRAIN = false;
    bf16_t* O; int ldc;
    __device__ __forceinline__ void operator()(const f32x4 (&acc)[2][2][4][2], const Unit& u, int wr, int wc, int fr, int fq) const {
        const int row0 = u.pm * BM + wr * 64 + fr, col0 = u.pn * HALF + wc * 32 + 8 * fq;
#pragma unroll
        for (int ai = 0; ai < 2; ++ai)
#pragma unroll
            for (int m = 0; m < 4; ++m) { bf16_t* rowp = O + (size_t)(row0 + ai * HALF + m * 16) * ldc + col0;
                const f32x4 g0 = acc[ai][0][m][0], g1 = acc[ai][0][m][1], u0 = acc[ai][1][m][0], u1 = acc[ai][1][m][1];
                u32x4 w;
                w.x = cvt_pk_bf16(silu_f(g0[0]) * u0[0], silu_f(g0[1]) * u0[1]); w.y = cvt_pk_bf16(silu_f(g0[2]) * u0[2], silu_f(g0[3]) * u0[3]);
                w.z = cvt_pk_bf16(silu_f(g1[0]) * u1[0], silu_f(g1[1]) * u1[1]); w.w = cvt_pk_bf16(silu_f(g1[2]) * u1[2], silu_f(g1[3]) * u1[3]);
                *(u32x4*)rowp = w; }
    }
};
struct EpiF32 {
    static constexpr bool PERM = false, AFTER_DRAIN = false;
    float* C; int ldc;
    __device__ __forceinline__ void operator()(const f32x4 (&acc)[2][2][4][2], const Unit& u, int wr, int wc, int fr, int fq) const {
        const int row0 = u.pm * BM + wr * 64 + fr, col0 = u.pn * BM + wc * 32 + 4 * fq;
#pragma unroll
        for (int ai = 0; ai < 2; ++ai)
#pragma unroll
            for (int m = 0; m < 4; ++m) { float* rowp = C + (size_t)(row0 + ai * HALF + m * 16) * ldc + col0;
#pragma unroll
                for (int bj = 0; bj < 2; ++bj)
#pragma unroll
                    for (int n = 0; n < 2; ++n) *(f32x4*)(rowp + bj * HALF + n * 16) = acc[ai][bj][m][n]; }
    }
};
template <class Epi, class Sched, bool ALIGN_EPI = false, bool SP2 = false>
__device__ __forceinline__ void gemm_phase(PG8_LAS unsigned char* lds, const Gemm g, const Sched& S, const Epi& E) {
    const int tid = threadIdx.x, wid = __builtin_amdgcn_readfirstlane(tid >> 6), lane = tid & 63, wr = wid >> 2, wc = wid & 3, fr = lane & 15, fq = lane >> 4;
    const int K = g.K, nt = K / BK;
    unsigned voffA[2], voffB[2];
#pragma unroll
    for (int i = 0; i < 2; ++i) { int R, C; stage_rc(tid * 16 + i * 8192, R, C); const int Rb = Epi::PERM ? ((R & ~31) + perm32(R & 31)) : R;
        voffA[i] = (unsigned)(R * K + C) * 2u; voffB[i] = (unsigned)(Rb * K + C) * 2u; }
    const size_t kstep = (size_t)(BK * 2);
    const size_t hstep = (size_t)HALF * K * 2;
    const size_t tstep = 2 * hstep;
    const unsigned ldsw = (unsigned)wid * 1024u;
    const int aoff = lds_byte(wr * 64 + fr, fq * 8), boff = lds_byte(wc * 32 + fr, fq * 8);
#define PG8_SA(b, h) (((b) * 2 + (h)) * HTB)
#define PG8_SB(b, h) ((4 + (b) * 2 + (h)) * HTB)
#define PG8_STAGE(bufoff, gbase, voff) do { _Pragma("unroll") for (int _i = 0; _i < 2; ++_i) \
        __builtin_amdgcn_global_load_lds((const unsigned*)((const char*)(gbase) + (voff)[_i]), (PG8_LAS unsigned*)(lds + (bufoff) + ldsw + _i * 8192), 16, 0, 0); } while (0)
#define PG8_LDA(dst, b, h) do { _Pragma("unroll") for (int m = 0; m < 4; ++m) _Pragma("unroll") for (int k = 0; k < 2; ++k) dst[m][k] = *(const PG8_LAS bf16x8*)(lds + PG8_SA(b, h) + aoff + m * 2048 + k * 1024); } while (0)
#define PG8_LDB(dst, b, h) do { _Pragma("unroll") for (int n = 0; n < 2; ++n) _Pragma("unroll") for (int k = 0; k < 2; ++k) dst[n][k] = *(const PG8_LAS bf16x8*)(lds + PG8_SB(b, h) + boff + n * 2048 + k * 1024); } while (0)
#define PG8_MMA(ai, bj, At, Bt) do { __builtin_amdgcn_s_setprio(1); _Pragma("unroll") for (int m = 0; m < 4; ++m) _Pragma("unroll") for (int n = 0; n < 2; ++n) _Pragma("unroll") for (int k = 0; k < 2; ++k) \
        acc[ai][bj][m][n] = __builtin_amdgcn_mfma_f32_16x16x32_bf16(Bt[n][k], At[m][k], acc[ai][bj][m][n], 0, 0, 0); __builtin_amdgcn_s_setprio(0); } while (0)
#define PG8_WAIT_V(n) asm volatile("s_waitcnt vmcnt(" #n ")" ::: "memory")
#define PG8_WAIT_L(n) asm volatile("s_waitcnt lgkmcnt(" #n ")" ::: "memory")
#define PG8_BAR __builtin_amdgcn_s_barrier()
#define PG8_SCHED __builtin_amdgcn_sched_barrier(0)
    Unit cur, nxt; int ui = 0;
    if (!S.next(0, cur)) return;
    f32x4 acc[2][2][4][2];
#pragma unroll
    for (int a = 0; a < 2; ++a)
#pragma unroll
        for (int b = 0; b < 2; ++b)
#pragma unroll
            for (int m = 0; m < 4; ++m)
#pragma unroll
                for (int n = 0; n < 2; ++n) acc[a][b][m][n] = (f32x4){0.f, 0.f, 0.f, 0.f};
    bf16x8 At[4][2], B0[2][2], B1[2][2];
    const char* cA = (const char*)g.A + (size_t)cur.pm * tstep; const char* cB = (const char*)g.Bt + (size_t)cur.pn * tstep;
    S.a_ready(cur);
    if constexpr (SP2) {
        PG8_STAGE(PG8_SB(0, 0), cB, voffB); PG8_STAGE(PG8_SB(0, 1), cB + hstep, voffB); PG8_STAGE(PG8_SA(0, 0), cA, voffA); PG8_STAGE(PG8_SA(0, 1), cA + hstep, voffA);
        if (wr == 1) PG8_BAR;
        PG8_WAIT_V(2); PG8_BAR;
        PG8_STAGE(PG8_SB(1, 0), cB + kstep, voffB); PG8_STAGE(PG8_SA(1, 0), cA + kstep, voffA); PG8_STAGE(PG8_SB(1, 1), cB + hstep + kstep, voffB);
        PG8_WAIT_V(6); PG8_BAR;
    } else {
        PG8_STAGE(PG8_SB(0, 0), cB, voffB); PG8_STAGE(PG8_SA(0, 0), cA, voffA); PG8_STAGE(PG8_SB(0, 1), cB + hstep, voffB); PG8_STAGE(PG8_SA(0, 1), cA + hstep, voffA);
        if (wr == 1) PG8_BAR;
        PG8_WAIT_V(4); PG8_BAR;
        PG8_STAGE(PG8_SB(1, 0), cB + kstep, voffB); PG8_STAGE(PG8_SA(1, 0), cA + kstep, voffA); PG8_STAGE(PG8_SB(1, 1), cB + hstep + kstep, voffB);
        PG8_WAIT_V(6); PG8_BAR;
    }
    for (;;) {
        const bool has_next = S.next(ui + 1, nxt);
        const char* nA = has_next ? (const char*)g.A + (size_t)nxt.pm * tstep : cA; const char* nB = has_next ? (const char*)g.Bt + (size_t)nxt.pn * tstep : cB;
        for (int t = 0; t < nt; t += 2) {
            const bool last = (t == nt - 2);
            const char* a1 = cA + (size_t)(t + 1) * kstep;
            const char* a2 = last ? nA : cA + (size_t)(t + 2) * kstep; const char* b2 = last ? nB : cB + (size_t)(t + 2) * kstep;
            const char* a3 = a2 + kstep; const char* b3 = b2 + kstep;
            if (last && has_next) S.a_ready(nxt);
            if constexpr (SP2) {
            PG8_LDB(B0, 0, 0); PG8_LDB(B1, 0, 1); PG8_SCHED; PG8_LDA(At, 0, 0); PG8_STAGE(PG8_SA(1, 1), a1 + hstep, voffA);
            PG8_WAIT_V(8); PG8_WAIT_L(0); PG8_BAR; PG8_MMA(0, 0, At, B0); PG8_MMA(0, 1, At, B1); PG8_BAR; PG8_SCHED;
            PG8_LDA(At, 0, 1); PG8_STAGE(PG8_SB(0, 0), b2, voffB); PG8_STAGE(PG8_SB(0, 1), b2 + hstep, voffB); PG8_STAGE(PG8_SA(0, 0), a2, voffA);
            PG8_WAIT_V(8); PG8_WAIT_L(0); PG8_BAR; PG8_MMA(1, 0, At, B0); PG8_MMA(1, 1, At, B1); PG8_BAR; PG8_SCHED;
            PG8_LDB(B0, 1, 0); PG8_LDB(B1, 1, 1); PG8_SCHED; PG8_LDA(At, 1, 0); PG8_STAGE(PG8_SA(0, 1), a2 + hstep, voffA);
            PG8_WAIT_V(8); PG8_WAIT_L(0); PG8_BAR; PG8_MMA(0, 0, At, B0); PG8_MMA(0, 1, At, B1); PG8_BAR; PG8_SCHED;
            PG8_LDA(At, 1, 1); PG8_STAGE(PG8_SB(1, 0), b3, voffB); PG8_STAGE(PG8_SB(1, 1), b3 + hstep, voffB); PG8_STAGE(PG8_SA(1, 0), a3, voffA);
            PG8_WAIT_V(8); PG8_WAIT_L(0); PG8_BAR; PG8_MMA(1, 0, At, B0); PG8_MMA(1, 1, At, B1); PG8_BAR; PG8_SCHED;
            } else {
            PG8_LDB(B0, 0, 0); PG8_SCHED; PG8_LDA(At, 0, 0); PG8_STAGE(PG8_SA(1, 1), a1 + hstep, voffA);
            PG8_WAIT_L(8); PG8_BAR; PG8_WAIT_L(0); PG8_MMA(0, 0, At, B0); PG8_BAR; PG8_SCHED;
            PG8_LDB(B1, 0, 1); PG8_STAGE(PG8_SB(0, 0), b2, voffB);
            PG8_BAR; PG8_WAIT_L(0); PG8_MMA(0, 1, At, B1); PG8_BAR;
            PG8_LDA(At, 0, 1); PG8_STAGE(PG8_SA(0, 0), a2, voffA);
            PG8_BAR; PG8_WAIT_L(0); PG8_MMA(1, 0, At, B0); PG8_BAR; PG8_SCHED;
            PG8_STAGE(PG8_SB(0, 1), b2 + hstep, voffB);
            PG8_WAIT_V(6); PG8_BAR; PG8_MMA(1, 1, At, B1); PG8_BAR;
            PG8_LDB(B0, 1, 0); PG8_SCHED; PG8_LDA(At, 1, 0); PG8_STAGE(PG8_SA(0, 1), a2 + hstep, voffA);
            PG8_WAIT_L(8); PG8_BAR; PG8_WAIT_L(0); PG8_MMA(0, 0, At, B0); PG8_BAR; PG8_SCHED;
            PG8_LDB(B1, 1, 1); PG8_STAGE(PG8_SB(1, 0), b3, voffB);
            PG8_BAR; PG8_WAIT_L(0); PG8_MMA(0, 1, At, B1); PG8_BAR;
            PG8_LDA(At, 1, 1); PG8_STAGE(PG8_SA(1, 0), a3, voffA);
            PG8_BAR; PG8_WAIT_L(0); PG8_MMA(1, 0, At, B0); PG8_BAR; PG8_SCHED;
            PG8_STAGE(PG8_SB(1, 1), b3 + hstep, voffB);
            PG8_WAIT_V(6); PG8_BAR; PG8_MMA(1, 1, At, B1); PG8_BAR;
            }
        }
        if constexpr (ALIGN_EPI) { if (wr == 0) PG8_BAR; }
        if constexpr (!Epi::AFTER_DRAIN) { E(acc, cur, wr, wc, fr, fq); S.done(cur); }
        if (!has_next) break;
#pragma unroll
        for (int a = 0; a < 2; ++a)
#pragma unroll
            for (int b = 0; b < 2; ++b)
#pragma unroll
                for (int m = 0; m < 4; ++m)
#pragma unroll
                    for (int n = 0; n < 2; ++n) acc[a][b][m][n] = (f32x4){0.f, 0.f, 0.f, 0.f};
        cur = nxt; cA = nA; cB = nB; ++ui;
        if constexpr (ALIGN_EPI) { if (wr == 1) PG8_BAR; }
    }
    PG8_WAIT_V(0);
    if constexpr (!ALIGN_EPI) { if (wr == 0) PG8_BAR; }
    PG8_BAR;
    if constexpr (Epi::AFTER_DRAIN) { E.fused(acc, cur, wr, wc, fr, fq, lds, wid, lane); S.done(cur); }
#undef PG8_SA
#undef PG8_SB
#undef PG8_STAGE
#undef PG8_LDA
#undef PG8_LDB
#undef PG8_MMA
#undef PG8_WAIT_V
#undef PG8_WAIT_L
#undef PG8_BAR
#undef PG8_SCHED
}
}

constexpr int NPHASE = 8;
#ifndef DUP_PHASE
#define DUP_PHASE -1
#endif
#define REPS(k) for (int rep_ = 0; rep_ < ((k) == DUP_PHASE ? 2 : 1); ++rep_)
constexpr int NB = 8, SEQ = 2048, D = 1024, NMETA = 16, WA = 512, WB = 512, NIN = 2560, FF = 2816, KB_W = 31;
constexpr int MX = NB * SEQ;
constexpr int M1 = 65 * 256;
constexpr float RMS_EPS = 1e-6f, LN_EPS = 1e-5f;

constexpr size_t MiB = 1u << 20;
constexpr size_t WS_CTL = 0, CTL_ZERO_BYTES = 65536;
constexpr size_t WS_WIN = 1 * MiB, WS_WOUT = 6 * MiB, WS_WGU = 8 * MiB, WS_WDN = 19 * MiB;
constexpr size_t WS_XN = 25 * MiB;
constexpr size_t WS_MIX = 58 * MiB;
constexpr size_t WS_HP = 122 * MiB;
constexpr size_t WS_Y = 204 * MiB;
constexpr size_t WS_ACT = 122 * MiB;
constexpr size_t WS_END = 236 * MiB;
static_assert(WS_WIN + (size_t)NIN * D * 2 <= WS_WOUT && WS_WOUT + (size_t)D * D * 2 <= WS_WGU && WS_WGU + (size_t)2 * FF * D * 2 <= WS_WDN && WS_WDN + (size_t)D * FF * 2 <= WS_XN, "ws map 1");
static_assert(WS_XN + (size_t)M1 * D * 2 <= WS_MIX && WS_MIX + (size_t)MX * D * 4 <= WS_HP && WS_HP + (size_t)M1 * NIN * 2 <= WS_Y && WS_Y + (size_t)MX * D * 2 <= WS_END && WS_ACT + (size_t)MX * FF * 2 <= WS_END, "ws map 2");

constexpr int LDS_BYTES = 147456;

#define LAS __attribute__((address_space(3)))
typedef unsigned short bf16;
typedef unsigned v4u __attribute__((ext_vector_type(4)));
typedef unsigned v2u __attribute__((ext_vector_type(2)));
typedef float f32x4 __attribute__((ext_vector_type(4)));
typedef float f32x2 __attribute__((ext_vector_type(2)));
#define LDS_WAIT() asm volatile("s_waitcnt lgkmcnt(0)" ::: "memory")
__device__ __forceinline__ unsigned pk2(float lo, float hi) { return pg8::cvt_pk_bf16(lo, hi); }
__device__ __forceinline__ float bf_lo(unsigned w) { return __uint_as_float(w << 16); }
__device__ __forceinline__ float bf_hi(unsigned w) { return __uint_as_float(w & 0xffff0000u); }
__device__ __forceinline__ float sigmoid_f(float a) { return __builtin_amdgcn_rcpf(1.0f + __builtin_amdgcn_exp2f(a * -1.44269504089f)); }
__device__ __forceinline__ float wave_sum(float v) {
#pragma unroll
    for (int o = 1; o < 64; o <<= 1) v += __shfl_xor(v, o);
    return v;
}
__device__ __forceinline__ float dot4(f32x4 a) { return (a.x * a.x + a.y * a.y) + (a.z * a.z + a.w * a.w); }

__device__ __forceinline__ void transpose_item(const float* W, int N, int K, bf16* WT, int k0, int n0, int orow0, LAS float* scr, int lane) {
#pragma unroll 8
    for (int i = 0; i < 32; ++i) { const int kk = 2 * i + (lane >> 5); scr[kk * 33 + (lane & 31)] = W[(size_t)(k0 + kk) * N + n0 + (lane & 31)]; }
    LDS_WAIT(); asm volatile("" ::: "memory");
    const int c = lane & 7;
#pragma unroll
    for (int j = 0; j < 4; ++j) { const int n = (lane >> 3) + 8 * j; const LAS float* s = scr + (8 * c) * 33 + n;
        v4u o; o.x = pk2(s[0 * 33], s[1 * 33]); o.y = pk2(s[2 * 33], s[3 * 33]); o.z = pk2(s[4 * 33], s[5 * 33]); o.w = pk2(s[6 * 33], s[7 * 33]);
        *(v4u*)(WT + (size_t)(orow0 + n) * K + k0 + 8 * c) = o; }
    LDS_WAIT(); asm volatile("" ::: "memory");
}
__device__ __forceinline__ void rms_row_to_bf16(const float* xrow, const float* gain, bf16* orow, int lane) {
    const f32x4* xr = (const f32x4*)xrow + lane; const f32x4* gr = (const f32x4*)gain + lane;
    f32x4 v[4]; float s = 0.f;
#pragma unroll
    for (int j = 0; j < 4; ++j) { v[j] = xr[64 * j]; s += dot4(v[j]); }
    const float r = 1.0f / sqrtf(wave_sum(s) * (1.0f / D) + RMS_EPS);
    v2u* o8 = (v2u*)orow + lane;
#pragma unroll
    for (int j = 0; j < 4; ++j) { const f32x4 g = gr[64 * j]; v2u w; w.x = pk2(v[j].x * r * g.x, v[j].y * r * g.y); w.y = pk2(v[j].z * r * g.z, v[j].w * r * g.w); o8[64 * j] = w; }
}

#define XB_TMO      128
#define XB_XCNT(j)  (256  + 64 * (j))
#define XB_XSUB(j)  (1280 + 64 * (j))
#define XB_XGEN(j)  (2304 + 64 * (j))
#define XB_TOP      3328
#define XB_TOPGEN   3392
#define XCD_BAR_WORDS 3456
#define XB_SPIN_CAP (1u << 18)

__device__ __forceinline__ unsigned xb_ld(unsigned* p)              { return __hip_atomic_load(p, __ATOMIC_RELAXED, __HIP_MEMORY_SCOPE_AGENT); }
__device__ __forceinline__ unsigned xb_add(unsigned* p, unsigned v) { return __hip_atomic_fetch_add(p, v, __ATOMIC_RELAXED, __HIP_MEMORY_SCOPE_AGENT); }
__device__ __forceinline__ unsigned xb_xcc_id() { return (unsigned)__builtin_amdgcn_s_getreg((3 << 11) | 20) & 0xFu; }
#define XB_SPIN(cond, bar) do { unsigned _sp = 0; while (cond) { __builtin_amdgcn_s_sleep(1); \
    if ((++_sp & 255u) == 0u) { if (xb_ld(&(bar)[XB_TMO])) break; if (_sp > XB_SPIN_CAP) { atomicAdd(&(bar)[XB_TMO], 1u); break; } } } } while (0)

struct XcdBarrier {
    unsigned* bar; unsigned x;
    volatile LAS unsigned* st;
};

__device__ __forceinline__ XcdBarrier xcd_barrier_post(unsigned* bar, volatile LAS unsigned* st) {
    XcdBarrier b; b.bar = bar; b.x = xb_xcc_id(); b.st = st;
    if (threadIdx.x == 0) (void)xb_add(&bar[XB_XCNT(b.x)], 1u);
    return b;
}
__device__ __forceinline__ void xcd_barrier_complete(unsigned* bar, unsigned x, unsigned& nloc, unsigned& nx) {
    const unsigned G = gridDim.x * gridDim.y * gridDim.z;
    unsigned sum, cnt, mine, sp = 0u;
    for (;;) {
        sum = 0u; cnt = 0u; mine = 0u;
#pragma unroll
        for (unsigned j = 0; j < 16; ++j) { const unsigned c = xb_ld(&bar[XB_XCNT(j)]); sum += c; cnt += (c > 0u) ? 1u : 0u; mine = (j == x) ? c : mine; }
        if (sum == G) break;
        __builtin_amdgcn_s_sleep(1);
        if ((++sp & 255u) == 0u) { if (xb_ld(&bar[XB_TMO])) break; if (sp > XB_SPIN_CAP) { atomicAdd(&bar[XB_TMO], 1u); break; } }
    }
    nloc = mine > 0u ? mine : 1u; nx = cnt > 0u ? cnt : 1u;
}

__device__ __forceinline__ void xcd_barrier(const XcdBarrier& b) {
    asm volatile("s_waitcnt vmcnt(0)" ::: "memory");
    __syncthreads();
    if (threadIdx.x == 0) {
        unsigned* bar = b.bar;
        __builtin_amdgcn_s_waitcnt(0);
        unsigned nloc = b.st[0], nx = b.st[1];
        if (nloc == 0u) { xcd_barrier_complete(bar, b.x, nloc, nx); b.st[0] = nloc; b.st[1] = nx; }
        const unsigned old = xb_add(&bar[XB_XSUB(b.x)], 1u);
        const unsigned gen = old / nloc;
        if (old + 1u == (gen + 1u) * nloc) {
            __builtin_amdgcn_fence(__ATOMIC_RELEASE, "agent");
            asm volatile("s_waitcnt vmcnt(0)" ::: "memory");
            const unsigned og = xb_add(&bar[XB_TOP], 1u);
            const unsigned tg = og / nx;
            if (og + 1u == (tg + 1u) * nx) xb_add(&bar[XB_TOPGEN], 1u);
            else XB_SPIN(xb_ld(&bar[XB_TOPGEN]) == tg, bar);
            __builtin_amdgcn_fence(__ATOMIC_ACQUIRE, "agent");
            xb_add(&bar[XB_XGEN(b.x)], 1u);
            asm volatile("s_waitcnt vmcnt(0)" ::: "memory");
        } else {
            XB_SPIN(xb_ld(&bar[XB_XGEN(b.x)]) == gen, bar);
            __builtin_amdgcn_fence(__ATOMIC_ACQUIRE, "agent");
            asm volatile("s_waitcnt vmcnt(0)" ::: "memory");
        }
    }
    __syncthreads();
}

struct Args { const float* in[16]; float* out; unsigned char* ws; int ph_lo, ph_hi; };

__device__ __forceinline__ void p0_prologue(const Args& a, LAS unsigned char* lds, int wave, int lane, int G) {
    LAS float* scr = (LAS float*)(lds + wave * 16384);
    const int gw = blockIdx.x * 8 + wave, NGW = G * 8;
    bf16* Win_t = (bf16*)(a.ws + WS_WIN); bf16* Wout_t = (bf16*)(a.ws + WS_WOUT); bf16* Wgu_t = (bf16*)(a.ws + WS_WGU); bf16* Wdn_t = (bf16*)(a.ws + WS_WDN);
    constexpr int I_IN = (D / 64) * (NIN / 32), I_OUT = (D / 64) * (D / 32), I_G = (D / 64) * (FF / 32), I_DN = (FF / 64) * (D / 32);
    constexpr int NITEMS = I_IN + I_OUT + 2 * I_G + I_DN;
    for (int it = gw; it < NITEMS; it += NGW) {
        int r = it;
        if (r < I_IN) { const int nb = NIN / 32, k0 = (r / nb) * 64, n0 = (r % nb) * 32; transpose_item(a.in[3], NIN, D, Win_t, k0, n0, n0, scr, lane); continue; } r -= I_IN;
        if (r < I_OUT) { const int nb = D / 32, k0 = (r / nb) * 64, n0 = (r % nb) * 32; transpose_item(a.in[9], D, D, Wout_t, k0, n0, n0, scr, lane); continue; } r -= I_OUT;
        if (r < I_G) { const int nb = FF / 32, k0 = (r / nb) * 64, n0 = (r % nb) * 32; transpose_item(a.in[12], FF, D, Wgu_t, k0, n0, (n0 >> 7) * 256 + (n0 & 127), scr, lane); continue; } r -= I_G;
        if (r < I_G) { const int nb = FF / 32, k0 = (r / nb) * 64, n0 = (r % nb) * 32; transpose_item(a.in[13], FF, D, Wgu_t, k0, n0, (n0 >> 7) * 256 + 128 + (n0 & 127), scr, lane); continue; } r -= I_G;
        { const int nb = D / 32, k0 = (r / nb) * 64, n0 = (r % nb) * 32; transpose_item(a.in[14], D, FF, Wdn_t, k0, n0, n0, scr, lane); }
    }
    bf16* XN = (bf16*)(a.ws + WS_XN);
    for (int m = gw; m < MX + NMETA; m += NGW) {
        const float* src = m < MX ? a.in[0] + (size_t)m * D : a.in[1] + (size_t)(m - MX) * D;
        rms_row_to_bf16(src, a.in[2], XN + (size_t)m * D, lane);
    }
}

constexpr int CV_TT = 64, CV_ROWS = CV_TT + KB_W - 1  , CV_ZOFF = CV_ROWS * 1024;
static_assert(CV_ZOFF + 16 * 512 * 4 <= 131072, "conv LDS");
__device__ __forceinline__ size_t hp_row(int b, int p) { return p < NMETA ? (size_t)(MX + p) : (size_t)(b * SEQ + p - NMETA); }
__device__ __forceinline__ void p2_conv(const Args& a, LAS unsigned char* lds, int tid, int wave, int lane, int G) {
    const bf16* HP = (const bf16*)(a.ws + WS_HP); bf16* Y = (bf16*)(a.ws + WS_Y);
    const float* conv_a_w = a.in[4]; const float* conv_b_w = a.in[5]; const float* conv_b_bias = a.in[6]; const float* ln_g = a.in[7]; const float* ln_b = a.in[8];
    const int cp = tid & 255, sub = tid >> 8;
    for (int unit = blockIdx.x; unit < NB * (SEQ / CV_TT); unit += G) {
        const int b = unit / (SEQ / CV_TT), t0 = (unit % (SEQ / CV_TT)) * CV_TT;
        for (int i = wave; i < CV_ROWS; i += 8) {
            const int p = t0 - 14 + i; v4u o = {0u, 0u, 0u, 0u};
            if (p >= 0) {
                const bf16* hp = HP + hp_row(b, p) * NIN;
                const v4u v = *(const v4u*)(hp + 1536 + 8 * lane), gt = *(const v4u*)(hp + 2048 + 8 * lane);
#pragma unroll
                for (int e = 0; e < 4; ++e) o[e] = pk2(bf_lo(v[e]) * sigmoid_f(bf_lo(gt[e])), bf_hi(v[e]) * sigmoid_f(bf_hi(gt[e])));
            }
            *(LAS v4u*)(lds + i * 1024 + lane * 16) = o;
        }
        {
            float wa[3][8];
#pragma unroll
            for (int k = 0; k < 3; ++k) { const f32x4 w0 = *(const f32x4*)(conv_a_w + k * WA + 8 * lane), w1 = *(const f32x4*)(conv_a_w + k * WA + 8 * lane + 4);
                wa[k][0] = w0.x; wa[k][1] = w0.y; wa[k][2] = w0.z; wa[k][3] = w0.w; wa[k][4] = w1.x; wa[k][5] = w1.y; wa[k][6] = w1.z; wa[k][7] = w1.w; }
            float u2[8], u1[8], u0[8];
#pragma unroll
            for (int e = 0; e < 8; ++e) { u2[e] = 0.f; u1[e] = 0.f; }
#pragma unroll
            for (int tt = -2; tt < 8; ++tt) {
                const int tk = t0 + wave * 8 + tt, p = NMETA + tk;
                const bf16* hp = HP + hp_row(b, p) * NIN;
                const v4u cg = *(const v4u*)(hp + 512 + 8 * lane), ha = *(const v4u*)(hp + 1024 + 8 * lane);
#pragma unroll
                for (int e = 0; e < 4; ++e) { u0[2 * e] = bf_lo(cg[e]) * bf_lo(ha[e]); u0[2 * e + 1] = bf_hi(cg[e]) * bf_hi(ha[e]); }
                if (tt >= 0) {
                    const v4u bg = *(const v4u*)(hp + 8 * lane); v4u o;
#pragma unroll
                    for (int e = 0; e < 4; ++e) {
                        const float y0 = bf_lo(bg[e]) * (wa[0][2 * e] * u2[2 * e] + wa[1][2 * e] * u1[2 * e] + wa[2][2 * e] * u0[2 * e]);
                        const float y1 = bf_hi(bg[e]) * (wa[0][2 * e + 1] * u2[2 * e + 1] + wa[1][2 * e + 1] * u1[2 * e + 1] + wa[2][2 * e + 1] * u0[2 * e + 1]);
                        o[e] = pk2(y0, y1); }
                    *(v4u*)(Y + (size_t)(b * SEQ + tk) * D + 8 * lane) = o;
                }
#pragma unroll
                for (int e = 0; e < 8; ++e) { u2[e] = u1[e]; u1[e] = u0[e]; }
            }
        }
        __syncthreads();
        {
            f32x2 wb[KB_W];
#pragma unroll
            for (int k = 0; k < KB_W; ++k) wb[k] = *(const f32x2*)(conv_b_w + k * WB + 2 * cp);
            const f32x2 cb = *(const f32x2*)(conv_b_bias + 2 * cp);
            const f32x4 lg0 = *(const f32x4*)(ln_g + 8 * lane), lg1 = *(const f32x4*)(ln_g + 8 * lane + 4), lb0 = *(const f32x4*)(ln_b + 8 * lane), lb1 = *(const f32x4*)(ln_b + 8 * lane + 4);
            for (int tb = 0; tb < 4; ++tb) {
                const int tl0 = sub * 32 + tb * 8;
                f32x2 z[8];
#pragma unroll
                for (int j = 0; j < 8; ++j) z[j] = cb;
#pragma unroll
                for (int r = 0; r < 8 + KB_W - 1; ++r) {
                    const unsigned gw = *(const LAS unsigned*)(lds + (tl0 + r) * 1024 + cp * 4); const f32x2 g = {bf_lo(gw), bf_hi(gw)};
#pragma unroll
                    for (int j = 0; j < 8; ++j) { const int k = r - j; if (k >= 0 && k < KB_W) z[j] += wb[k] * g; }
                }
#pragma unroll
                for (int j = 0; j < 8; ++j) *(LAS f32x2*)(lds + CV_ZOFF + ((sub * 8 + j) * 512 + 2 * cp) * 4) = z[j];
                __syncthreads();
#pragma unroll
                for (int q = 0; q < 2; ++q) {
                    const LAS f32x4* zr = (const LAS f32x4*)(lds + CV_ZOFF + ((q * 8 + wave) * 512 + 8 * lane) * 4);
                    f32x4 z0 = zr[0], z1 = zr[1];
                    const float mean = wave_sum((z0.x + z0.y) + (z0.z + z0.w) + (z1.x + z1.y) + (z1.z + z1.w)) * (1.0f / WB);
                    z0 = z0 - mean; z1 = z1 - mean;
                    const float rstd = 1.0f / sqrtf(wave_sum(dot4(z0) + dot4(z1)) * (1.0f / WB) + LN_EPS);
                    z0 = z0 * rstd * lg0 + lb0; z1 = z1 * rstd * lg1 + lb1;
                    v4u o; o.x = pk2(pg8::silu_f(z0.x), pg8::silu_f(z0.y)); o.y = pk2(pg8::silu_f(z0.z), pg8::silu_f(z0.w)); o.z = pk2(pg8::silu_f(z1.x), pg8::silu_f(z1.y)); o.w = pk2(pg8::silu_f(z1.z), pg8::silu_f(z1.w));
                    const int tk = t0 + q * 32 + tb * 8 + wave;
                    *(v4u*)(Y + (size_t)(b * SEQ + tk) * D + WA + 8 * lane) = o;
                }
                __syncthreads();
            }
        }
    }
}

__device__ __forceinline__ void p4_norm(const Args& a, int wave, int lane, int G) {
    const int gw = blockIdx.x * 8 + wave, NGW = G * 8;
    const float* MIX = (const float*)(a.ws + WS_MIX); bf16* XN = (bf16*)(a.ws + WS_XN);
    const f32x4* g1 = (const f32x4*)a.in[10] + lane; const f32x4* g2 = (const f32x4*)a.in[11] + lane;
    for (int m = gw; m < MX; m += NGW) {
        const f32x4* mr = (const f32x4*)(MIX + (size_t)m * D) + lane; const f32x4* xr = (const f32x4*)(a.in[0] + (size_t)m * D) + lane; f32x4* orow = (f32x4*)(a.out + (size_t)m * D) + lane;
        f32x4 v[4], xv[4]; float s = 0.f;
#pragma unroll
        for (int j = 0; j < 4; ++j) { v[j] = mr[64 * j]; xv[j] = xr[64 * j]; s += dot4(v[j]); }
        const float r = 1.0f / sqrtf(wave_sum(s) * (1.0f / D) + RMS_EPS); float s2 = 0.f;
#pragma unroll
        for (int j = 0; j < 4; ++j) { v[j] = xv[j] + v[j] * r * g1[64 * j]; orow[64 * j] = v[j]; s2 += dot4(v[j]); }
        const float r2 = 1.0f / sqrtf(wave_sum(s2) * (1.0f / D) + RMS_EPS);
        v2u* o8 = (v2u*)(XN + (size_t)m * D) + lane;
#pragma unroll
        for (int j = 0; j < 4; ++j) { const f32x4 g = g2[64 * j]; v2u w; w.x = pk2(v[j].x * r2 * g.x, v[j].y * r2 * g.y); w.y = pk2(v[j].z * r2 * g.z, v[j].w * r2 * g.w); o8[64 * j] = w; }
    }
}
__device__ __forceinline__ void p7_norm(const Args& a, int wave, int lane, int G) {
    const int gw = blockIdx.x * 8 + wave, NGW = G * 8;
    const float* FFO = (const float*)(a.ws + WS_MIX);
    const f32x4* g1 = (const f32x4*)a.in[15] + lane;
    for (int m = gw; m < MX; m += NGW) {
        const f32x4* fr = (const f32x4*)(FFO + (size_t)m * D) + lane; f32x4* orow = (f32x4*)(a.out + (size_t)m * D) + lane;
        f32x4 v[4], hv[4]; float s = 0.f;
#pragma unroll
        for (int j = 0; j < 4; ++j) { v[j] = fr[64 * j]; hv[j] = orow[64 * j]; s += dot4(v[j]); }
        const float r = 1.0f / sqrtf(wave_sum(s) * (1.0f / D) + RMS_EPS);
#pragma unroll
        for (int j = 0; j < 4; ++j) orow[64 * j] = hv[j] + v[j] * r * g1[64 * j];
    }
}

__global__ void __launch_bounds__(512, 2) fwd_megakernel(Args a) {
    extern __shared__ __attribute__((aligned(16))) unsigned char lds_raw[];
    LAS unsigned char* lds = (LAS unsigned char*)lds_raw;
    cg::grid_group grid = cg::this_grid();
    const int tid = threadIdx.x, lane = tid & 63, wave = __builtin_amdgcn_readfirstlane(tid >> 6), G = gridDim.x;
    const int lo = a.ph_lo, hi = a.ph_hi;
    if (hi > NPHASE) grid.sync();
    volatile LAS unsigned* MISC = (volatile LAS unsigned*)(lds + 131072);
    if (tid < 64) MISC[tid] = 0u;
    __syncthreads();
    XcdBarrier bar = xcd_barrier_post((unsigned*)(a.ws + WS_CTL), MISC + 8);
#define IN(k) (lo <= (k) && (k) < hi)
#ifndef NSYNC
#define NSYNC 1
#endif
#define SEAM(k) do { if (IN(k) && IN((k) + 1)) for (int s_ = 0; s_ < NSYNC; ++s_) xcd_barrier(bar); } while (0)
    bf16* XN = (bf16*)(a.ws + WS_XN); bf16* HP = (bf16*)(a.ws + WS_HP); bf16* Y = (bf16*)(a.ws + WS_Y); bf16* ACT = (bf16*)(a.ws + WS_ACT); float* MIX = (float*)(a.ws + WS_MIX);
    const bf16* Win_t = (const bf16*)(a.ws + WS_WIN); const bf16* Wout_t = (const bf16*)(a.ws + WS_WOUT); const bf16* Wgu_t = (const bf16*)(a.ws + WS_WGU); const bf16* Wdn_t = (const bf16*)(a.ws + WS_WDN);

    if (IN(0)) REPS(0) { p0_prologue(a, lds, wave, lane, G); } SEAM(0);
    if (IN(1)) REPS(1) {
        pg8::Gemm g{XN, Win_t, M1, NIN, D}; pg8::StaticOrder S; S.init(M1, NIN, G, (int)blockIdx.x);
        pg8::EpiBf16 E{HP, NIN};
        pg8::gemm_phase<pg8::EpiBf16, pg8::StaticOrder, true, true>(lds, g, S, E);
    } SEAM(1);
    if (IN(2)) REPS(2) { p2_conv(a, lds, tid, wave, lane, G); } SEAM(2);
    if (IN(3)) REPS(3) {
        pg8::Gemm g{Y, Wout_t, MX, D, D}; pg8::StaticOrder S; S.init(MX, D, G, (int)blockIdx.x);
        pg8::EpiF32 E{MIX, D};
        pg8::gemm_phase<pg8::EpiF32, pg8::StaticOrder, true, true>(lds, g, S, E);
    } SEAM(3);
    if (IN(4)) REPS(4) { p4_norm(a, wave, lane, G); } SEAM(4);
    if (IN(5)) REPS(5) {
        pg8::Gemm g{XN, Wgu_t, MX, 2 * FF, D}; pg8::StaticOrder S; S.init(MX, 2 * FF, G, (int)blockIdx.x);
        pg8::EpiSwiGlu E{ACT, FF};
        pg8::gemm_phase<pg8::EpiSwiGlu, pg8::StaticOrder, true, true>(lds, g, S, E);
    } SEAM(5);
    if (IN(6)) REPS(6) {
        pg8::Gemm g{ACT, Wdn_t, MX, D, FF}; pg8::StaticOrder S; S.init(MX, D, G, (int)blockIdx.x);
        pg8::EpiF32 E{MIX, D};
        pg8::gemm_phase<pg8::EpiF32, pg8::StaticOrder, true, true>(lds, g, S, E);
    } SEAM(6);
    if (IN(7)) { p7_norm(a, wave, lane, G); }
#undef IN
#undef SEAM
}

extern "C" void kernel_launch(void* const* d_in, const int* in_sizes, int n_in, void* d_out, int out_size, void* d_ws, size_t ws_size, hipStream_t stream) {
    static int grid = 0;
    if (grid == 0) {
        if (n_in != 16 || in_sizes[0] != MX * D || out_size != MX * D || ws_size < WS_END) { fprintf(stderr, "kernel_launch: unexpected shapes (n_in %d, in0 %d, out %d, ws %zu); nothing launched\n", n_in, n_in > 0 ? in_sizes[0] : -1, out_size, ws_size); grid = -1; return; }
        int dev = 0, cus = 0, per_cu = 0;
        if (hipGetDevice(&dev) != hipSuccess || hipDeviceGetAttribute(&cus, hipDeviceAttributeMultiprocessorCount, dev) != hipSuccess) { grid = -1; return; }
        if (hipFuncSetAttribute((const void*)fwd_megakernel, hipFuncAttributeMaxDynamicSharedMemorySize, LDS_BYTES) != hipSuccess) { fprintf(stderr, "kernel_launch: hipFuncSetAttribute failed\n"); grid = -1; return; }
        if (hipOccupancyMaxActiveBlocksPerMultiprocessor(&per_cu, (const void*)fwd_megakernel, 512, LDS_BYTES) != hipSuccess || per_cu < 1) { fprintf(stderr, "kernel_launch: occupancy query says %d\n", per_cu); per_cu = 1; }
        (void)hipGetLastError();
        grid = cus * per_cu;
    }
    if (grid < 0) return;
    Args a{};
    for (int i = 0; i < 16; ++i) a.in[i] = (const float*)d_in[i];
    a.out = (float*)d_out; a.ws = (unsigned char*)d_ws;
    if (hipMemsetAsync((char*)d_ws + WS_CTL, 0, CTL_ZERO_BYTES, stream) != hipSuccess) { fprintf(stderr, "kernel_launch: memset failed\n"); return; }
    a.ph_lo = 0; a.ph_hi = NPHASE;
    void* args[] = {&a};
    hipError_t e = hipLaunchCooperativeKernel((const void*)fwd_megakernel, dim3(grid), dim3(512), args, LDS_BYTES, stream);
    if (e != hipSuccess) fprintf(stderr, "kernel_launch: cooperative launch failed: %s (grid %d)\n", hipGetErrorString(e), grid);
}
```
